# Optimizing an MI355X kernel written in HIP

```python
import math
import jax, jax.numpy as jnp
from jax import lax
import numpy as np

D_MODEL = 1024
BATCH = 4
SEQ = 4096
DEPTH = 1

GRID_W = 64
HEAD_DIM = 64
NA_HEADS = 8
NA_KH_MAX = 8
NA_KW = 16
NA_QBLK = 16
NA_BAND = 2 * NA_KW
NA_W = NA_HEADS * HEAD_DIM
GQA_HEADS = 8
GQA_KV_HEADS = 2
GQA_QBLK = 128
ROPE_THETA = 10000.0
GQA_Q_W = GQA_HEADS * HEAD_DIM
GQA_KV_W = GQA_KV_HEADS * HEAD_DIM
MEM_TOKENS = 256
MEM_HEADS = 4
MEM_HEAD_DIM = 128
MEM_W = MEM_HEADS * MEM_HEAD_DIM
N_BRANCH = 3
BRANCH_WIDTH = 512
GATE_W = N_BRANCH * D_MODEL
IN_W = 3 * NA_W + GQA_Q_W + 2 * GQA_KV_W + MEM_W + GATE_W
N_EXPERTS = 16
EC_CAPACITY_FACTOR = 2
D_FF_EXPERT = 1024
LN_EPS = 1e-5
RMS_EPS = 1e-6
DN_ALPHA = (2 * DEPTH) ** 0.25
DN_BETA = (8 * DEPTH) ** -0.25
NEG_INF = -1e30

kernel_name = "hybrid_natten_gqa_mem_ec_moe_deepnorm"


def _split_points():
    sizes = (NA_W, NA_W, NA_W, GQA_Q_W, GQA_KV_W, GQA_KV_W, MEM_W)
    return tuple(int(v) for v in np.cumsum(sizes))


def layer_norm(x, g, b):
    xf = x.astype(jnp.float32)
    mu = jnp.mean(xf, axis=-1, keepdims=True)
    var = jnp.mean(jnp.square(xf - mu), axis=-1, keepdims=True)
    return ((xf - mu) * lax.rsqrt(var + LN_EPS) * g.astype(jnp.float32) + b.astype(jnp.float32)).astype(x.dtype)


def rms_norm(x, g):
    xf = x.astype(jnp.float32)
    ms = jnp.mean(jnp.square(xf), axis=-1, keepdims=True)
    return (xf * lax.rsqrt(ms + RMS_EPS) * g.astype(jnp.float32)).astype(x.dtype)


def axial_rope_tables(seq_len):
    t = jnp.arange(seq_len)
    row = (t // GRID_W).astype(jnp.float32)
    col = (t % GRID_W).astype(jnp.float32)
    half = HEAD_DIM // 2
    inv = ROPE_THETA ** (-jnp.arange(0, half, 2, dtype=jnp.float32) / half)
    ang = jnp.concatenate([row[:, None] * inv, col[:, None] * inv], axis=-1)
    return jnp.cos(ang), jnp.sin(ang)


def apply_rope(x, cos, sin):
    xf = x.astype(jnp.float32)
    x1, x2 = xf[..., 0::2], xf[..., 1::2]
    c, s = cos[None, :, None, :], sin[None, :, None, :]
    out = jnp.stack([x1 * c - x2 * s, x1 * s + x2 * c], axis=-1).reshape(x.shape)
    return out.astype(x.dtype)


def neighbourhood_attention(q, k, v, rpb):
    S, H, dh = q.shape
    rows = S // GRID_W
    kh = min(NA_KH_MAX, rows)
    ncb = GRID_W // NA_QBLK
    qg = q.reshape(rows, ncb, NA_QBLK, H, dh)
    kg = k.reshape(rows, GRID_W, H, dh)
    vg = v.reshape(rows, GRID_W, H, dh)
    r = jnp.arange(rows)
    row_start = jnp.clip(r - kh // 2, 0, rows - kh)
    key_rows = row_start[:, None] + jnp.arange(kh)
    cb = jnp.arange(ncb)
    band_start = jnp.clip(cb * NA_QBLK - NA_KW // 2, 0, GRID_W - NA_BAND)
    key_cols = band_start[:, None] + jnp.arange(NA_BAND)
    ri = key_rows[:, None, :, None]
    ci = key_cols[None, :, None, :]
    k_blk = kg[ri, ci]
    v_blk = vg[ri, ci]
    qcol = cb[:, None] * NA_QBLK + jnp.arange(NA_QBLK)
    col_start = jnp.clip(qcol - NA_KW // 2, 0, GRID_W - NA_KW)
    kc = key_cols[:, None, :]
    in_win = (kc >= col_start[:, :, None]) & (kc < col_start[:, :, None] + NA_KW)
    dr = key_rows - r[:, None]
    dc = jnp.clip(kc - qcol[:, :, None] + NA_KW - 1, 0, 2 * NA_KW - 2)
    bias = rpb[:, (dr + NA_KH_MAX - 1)[:, None, None, :, None], dc[None, :, :, None, :]]
    scores = jnp.einsum('rcqhd,rckwhd->hrcqkw', qg, k_blk,
                        preferred_element_type=jnp.float32) * (1.0 / math.sqrt(dh))
    scores = jnp.where(in_win[None, None, :, :, None, :], scores + bias.astype(jnp.float32), NEG_INF)
    p = jax.nn.softmax(scores, axis=(-2, -1))
    out = jnp.einsum('hrcqkw,rckwhd->rcqhd', p.astype(v.dtype), v_blk)
    return out.reshape(S, H * dh)


def gqa_attention(q, k, v, q_gain, k_gain, cos, sin):
    q = apply_rope(rms_norm(q, q_gain), cos, sin)
    k = apply_rope(rms_norm(k, k_gain), cos, sin)
    B, S, Hq, dh = q.shape
    hkv = k.shape[2]
    grp = Hq // hkv
    nblk = S // GQA_QBLK
    qb = q.reshape(B, nblk, GQA_QBLK, hkv, grp, dh).transpose(1, 0, 3, 4, 2, 5)
    scale = 1.0 / math.sqrt(dh)

    def block(qi):
        s = jnp.einsum('bkgqd,bskd->bkgqs', qi, k, preferred_element_type=jnp.float32) * scale
        p = jax.nn.softmax(s, axis=-1)
        return jnp.einsum('bkgqs,bskd->bqkgd', p.astype(v.dtype), v)

    out = lax.map(block, qb)
    return out.transpose(1, 0, 2, 3, 4, 5).reshape(B, S, Hq * dh)


def memory_attention(q, mk, mv):
    B, S, H, dm = q.shape
    s = jnp.einsum('bshd,bmhd->bhsm', q, mk, preferred_element_type=jnp.float32) * (1.0 / math.sqrt(dm))
    p = jax.nn.softmax(s, axis=-1)
    return jnp.einsum('bhsm,bmhd->bshd', p.astype(mv.dtype), mv).reshape(B, S, H * dm)


def expert_choice_ffn(x, w_router, w_gate_up, w_down):
    B, T, D = x.shape
    cap = EC_CAPACITY_FACTOR * T // N_EXPERTS
    logits = jnp.einsum('btd,de->bte', x, w_router, preferred_element_type=jnp.float32)
    aff = jax.nn.softmax(logits, axis=-1)
    gate, idx = lax.top_k(jnp.swapaxes(aff, 1, 2), cap)
    bidx = jnp.arange(B)[:, None, None]
    xs = x[bidx, idx]
    h = jnp.einsum('becd,edf->becf', xs, w_gate_up)
    hg, hu = jnp.split(h, 2, axis=-1)
    ye = jnp.einsum('becf,efd->becd', jax.nn.silu(hg) * hu, w_down)
    ye = ye * gate[..., None].astype(ye.dtype)
    return jnp.zeros_like(x).at[bidx, idx].add(ye)


def setup_inputs(seed: int = 0) -> dict:
    key = jax.random.key(seed)
    ks = jax.random.split(key, 20)

    def nrm(k, shape, scale):
        return jax.random.normal(k, shape, jnp.float32) * scale

    return {
        "x": nrm(ks[0], (BATCH, SEQ, D_MODEL), 1.0),
        "mem": nrm(ks[1], (BATCH, MEM_TOKENS, D_MODEL), 1.0),
        "w_in": nrm(ks[2], (DEPTH, D_MODEL, IN_W), D_MODEL ** -0.5),
        "b_gate": nrm(ks[3], (DEPTH, GATE_W), 0.1),
        "na_rpb": nrm(ks[4], (DEPTH, NA_HEADS, 2 * NA_KH_MAX - 1, 2 * NA_KW - 1), 0.05),
        "gqa_q_gain": 1.0 + nrm(ks[5], (DEPTH, HEAD_DIM), 0.1),
        "gqa_k_gain": 1.0 + nrm(ks[6], (DEPTH, HEAD_DIM), 0.1),
        "w_mem_kv": nrm(ks[7], (DEPTH, D_MODEL, 2 * MEM_W), D_MODEL ** -0.5),
        "w_branch": nrm(ks[8], (DEPTH, N_BRANCH, BRANCH_WIDTH, D_MODEL), BRANCH_WIDTH ** -0.5),
        "w_out": nrm(ks[9], (DEPTH, D_MODEL, D_MODEL), D_MODEL ** -0.5 * DN_BETA),
        "ln1_g": 1.0 + nrm(ks[10], (DEPTH, D_MODEL), 0.1),
        "ln1_b": nrm(ks[11], (DEPTH, D_MODEL), 0.02),
        "w_router": nrm(ks[12], (DEPTH, D_MODEL, N_EXPERTS), D_MODEL ** -0.5),
        "w_gate_up": nrm(ks[13], (DEPTH, N_EXPERTS, D_MODEL, 2 * D_FF_EXPERT), D_MODEL ** -0.5),
        "w_down": nrm(ks[14], (DEPTH, N_EXPERTS, D_FF_EXPERT, D_MODEL), D_FF_EXPERT ** -0.5 * DN_BETA),
        "ln2_g": 1.0 + nrm(ks[15], (DEPTH, D_MODEL), 0.1),
        "ln2_b": nrm(ks[16], (DEPTH, D_MODEL), 0.02),
    }


def reference(x, mem, w_in, b_gate, na_rpb, gqa_q_gain, gqa_k_gain, w_mem_kv, w_branch, w_out,
              ln1_g, ln1_b, w_router, w_gate_up, w_down, ln2_g, ln2_b):
    B, S, D = x.shape
    M = mem.shape[1]
    cos, sin = axial_rope_tables(S)
    for l in range(DEPTH):
        z = jnp.einsum('bsd,df->bsf', x, w_in[l])
        q_na, k_na, v_na, q_g, k_g, v_g, q_m, gate_logits = jnp.split(z, _split_points(), axis=-1)
        rpb = na_rpb[l]
        y_na = lax.map(lambda qkv: neighbourhood_attention(qkv[0], qkv[1], qkv[2], rpb),
                       (q_na.reshape(B, S, NA_HEADS, HEAD_DIM),
                        k_na.reshape(B, S, NA_HEADS, HEAD_DIM),
                        v_na.reshape(B, S, NA_HEADS, HEAD_DIM)))
        y_gqa = gqa_attention(q_g.reshape(B, S, GQA_HEADS, HEAD_DIM),
                              k_g.reshape(B, S, GQA_KV_HEADS, HEAD_DIM),
                              v_g.reshape(B, S, GQA_KV_HEADS, HEAD_DIM),
                              gqa_q_gain[l], gqa_k_gain[l], cos, sin)
        mkv = jnp.einsum('bmd,df->bmf', mem, w_mem_kv[l])
        mk, mv = jnp.split(mkv, 2, axis=-1)
        y_mem = memory_attention(q_m.reshape(B, S, MEM_HEADS, MEM_HEAD_DIM),
                                 mk.reshape(B, M, MEM_HEADS, MEM_HEAD_DIM),
                                 mv.reshape(B, M, MEM_HEADS, MEM_HEAD_DIM))
        branches = jnp.stack([y_na, y_gqa, y_mem], axis=2)
        proj = jnp.einsum('bsgk,gkd->bsgd', branches, w_branch[l])
        gates = jax.nn.sigmoid(gate_logits + b_gate[l]).reshape(B, S, N_BRANCH, D)
        merged = jnp.sum(gates * proj, axis=2)
        mix = jnp.einsum('bsd,de->bse', merged, w_out[l])
        x = layer_norm(DN_ALPHA * x + mix, ln1_g[l], ln1_b[l])
        ffn = expert_choice_ffn(x, w_router[l], w_gate_up[l], w_down[l])
        x = layer_norm(DN_ALPHA * x + ffn, ln2_g[l], ln2_b[l])
    return x
```

```cpp
#include <hip/hip_runtime.h>
#include <stdint.h>
#include <math.h>

namespace nv {
constexpr int D = 1024, NB = 4, S = 4096, T = NB * S, GW = 64, ROWS = 64, HD = 64;
constexpr int INW = 5888, ZA = 2816, GATEW = 3072;
constexpr int OFF_QNA = 0, OFF_KNA = 512, OFF_VNA = 1024, OFF_QG = 1536, OFF_KG = 2048, OFF_VG = 2176, OFF_QM = 2304;
constexpr int NE = 16, CAP = 512, DFF = 1024;
constexpr float LN_EPS = 1e-5f, RMS_EPS = 1e-6f;
constexpr float ALPHA = 1.189207115002721f;

template <class Epi, bool GATHER, bool DUAL>
__global__ void __launch_bounds__(256) gemm_naive(const float* __restrict__ A, int lda, const int* __restrict__ rowidx, int m_per_batch,
                                                  const float* __restrict__ Bm, int ldb, long bstride, int bmod, int K, int dualoff, Epi epi) {
    __shared__ float As[16][68];
    __shared__ float Bs[16][64];
    __shared__ float Bs2[DUAL ? 16 : 1][64];
    const int tid = threadIdx.x, tx = tid & 15, ty = tid >> 4;
    const int z = blockIdx.z;
    const int row0 = z * m_per_batch + blockIdx.y * 64, col0 = blockIdx.x * 64;
    const float* Bz = Bm + (long)(z % bmod) * bstride;
    const int ar = tid >> 2, ak = (tid & 3) * 4;
    const int grow = row0 + ar;
    const float* Arow = GATHER ? (A + (size_t)rowidx[grow] * lda) : (A + (size_t)grow * lda);
    const int bk = tid >> 4, bn = (tid & 15) * 4;
    float acc[4][4], acc2[4][4];
#pragma unroll
    for (int i = 0; i < 4; ++i)
#pragma unroll
        for (int j = 0; j < 4; ++j) { acc[i][j] = 0.f; acc2[i][j] = 0.f; }
    for (int k0 = 0; k0 < K; k0 += 16) {
        const float4 av = *(const float4*)(Arow + k0 + ak);
        const float4 bv = *(const float4*)(Bz + (size_t)(k0 + bk) * ldb + col0 + bn);
        float4 bv2 = bv;
        if (DUAL) bv2 = *(const float4*)(Bz + (size_t)(k0 + bk) * ldb + col0 + dualoff + bn);
        __syncthreads();
        As[ak + 0][ar] = av.x; As[ak + 1][ar] = av.y; As[ak + 2][ar] = av.z; As[ak + 3][ar] = av.w;
        *(float4*)&Bs[bk][bn] = bv;
        if (DUAL) *(float4*)&Bs2[bk][bn] = bv2;
        __syncthreads();
#pragma unroll
        for (int kk = 0; kk < 16; ++kk) {
            const float4 a = *(const float4*)&As[kk][ty * 4];
            const float4 b = *(const float4*)&Bs[kk][tx * 4];
            const float aa[4] = {a.x, a.y, a.z, a.w}, bb[4] = {b.x, b.y, b.z, b.w};
#pragma unroll
            for (int i = 0; i < 4; ++i)
#pragma unroll
                for (int j = 0; j < 4; ++j) acc[i][j] = fmaf(aa[i], bb[j], acc[i][j]);
            if (DUAL) {
                const float4 b2 = *(const float4*)&Bs2[kk][tx * 4];
                const float bb2[4] = {b2.x, b2.y, b2.z, b2.w};
#pragma unroll
                for (int i = 0; i < 4; ++i)
#pragma unroll
                    for (int j = 0; j < 4; ++j) acc2[i][j] = fmaf(aa[i], bb2[j], acc2[i][j]);
            }
        }
    }
#pragma unroll
    for (int i = 0; i < 4; ++i)
#pragma unroll
        for (int j = 0; j < 4; ++j) epi(row0 + ty * 4 + i, col0 + tx * 4 + j, acc[i][j], acc2[i][j]);
}

struct EpiStore { float* C; int ldc; int pad; __device__ void operator()(int r, int c, float a, float) const { C[(size_t)r * ldc + c] = a; } };
struct EpiGate { float* C; const float* bias; __device__ void operator()(int r, int c, float a, float) const { C[(size_t)r * GATEW + c] = 1.f / (1.f + expf(-(a + bias[c]))); } };
struct EpiMerge { float* C; const float* gates; int g; int pad; __device__ void operator()(int r, int c, float a, float) const {
    const float v = gates[(size_t)r * GATEW + g * D + c] * a; float* p = C + (size_t)r * D + c; if (g == 0) *p = v; else *p += v; } };
struct EpiResid { float* C; const float* x; __device__ void operator()(int r, int c, float a, float) const { C[(size_t)r * D + c] = ALPHA * x[(size_t)r * D + c] + a; } };
struct EpiSwiglu { float* C; __device__ void operator()(int r, int c, float a, float u) const { C[(size_t)r * DFF + c] = (a / (1.f + expf(-a))) * u; } };
struct EpiDown { float* C; const float* gatev; __device__ void operator()(int r, int c, float a, float) const { C[(size_t)r * D + c] = a * gatev[r]; } };

__global__ void __launch_bounds__(64) na_attn_naive(const float* __restrict__ z, const float* __restrict__ rpb, float* __restrict__ y) {
    const int gid = blockIdx.x * 64 + threadIdx.x;
    const int t = gid % S, h = (gid / S) % 8, b = gid / (S * 8);
    const int r = t / GW, c = t % GW;
    int rs = r - 4; rs = rs < 0 ? 0 : (rs > ROWS - 8 ? ROWS - 8 : rs);
    int cs = c - 8; cs = cs < 0 ? 0 : (cs > GW - 16 ? GW - 16 : cs);
    const float* zb = z + (size_t)b * S * ZA;
    float q[64], o[64];
    const float* qp = zb + (size_t)t * ZA + OFF_QNA + h * 64;
#pragma unroll
    for (int d = 0; d < 64; ++d) { q[d] = qp[d]; o[d] = 0.f; }
    float m = -1e30f, l = 0.f;
    for (int kr = 0; kr < 8; ++kr)
        for (int kc = 0; kc < 16; ++kc) {
            const int krow = rs + kr, kcol = cs + kc, kt = krow * GW + kcol;
            const float* kp = zb + (size_t)kt * ZA + OFF_KNA + h * 64;
            float s = 0.f;
#pragma unroll
            for (int d = 0; d < 64; ++d) s = fmaf(q[d], kp[d], s);
            s = s * 0.125f + rpb[(h * 15 + (krow - r + 7)) * 31 + (kcol - c + 15)];
            const float mn = fmaxf(m, s), f = expf(m - mn), p = expf(s - mn);
            l = l * f + p; m = mn;
            const float* vp = zb + (size_t)kt * ZA + OFF_VNA + h * 64;
#pragma unroll
            for (int d = 0; d < 64; ++d) o[d] = fmaf(p, vp[d], o[d] * f);
        }
    const float il = 1.f / l;
    float* yp = y + (size_t)(b * S + t) * 512 + h * 64;
#pragma unroll
    for (int d = 0; d < 64; ++d) yp[d] = o[d] * il;
}

__device__ __forceinline__ void sincos_acc(float ang, float& sn, float& cs) {
    const double a = (double)ang;
    const double k = rint(a * 0.63661977236758134308);
    const double y = fma(-k, 1.57079632679489661923, a) - k * 6.123233995736766e-17;
    const double y2 = y * y;
    double s = -1.0 / 1307674368000.0;
    s = fma(s, y2, 1.0 / 6227020800.0); s = fma(s, y2, -1.0 / 39916800.0); s = fma(s, y2, 1.0 / 362880.0); s = fma(s, y2, -1.0 / 5040.0);
    s = fma(s, y2, 1.0 / 120.0); s = fma(s, y2, -1.0 / 6.0); s = fma(s * y2, y, y);
    double c = 1.0 / 20922789888000.0;
    c = fma(c, y2, -1.0 / 87178291200.0); c = fma(c, y2, 1.0 / 479001600.0); c = fma(c, y2, -1.0 / 3628800.0); c = fma(c, y2, 1.0 / 40320.0);
    c = fma(c, y2, -1.0 / 720.0); c = fma(c, y2, 1.0 / 24.0); c = fma(c, y2, -0.5); c = fma(c, y2, 1.0);
    const int q = ((int)k) & 3;
    const double ss = (q == 0) ? s : (q == 1) ? c : (q == 2) ? -s : -c;
    const double cc = (q == 0) ? c : (q == 1) ? -s : (q == 2) ? -c : s;
    sn = (float)ss; cs = (float)cc;
}
__device__ __forceinline__ float rope_inv(int ii) { return (float)exp2(-(double)ii * 0.83048202372184059); }

__global__ void __launch_bounds__(64) gqa_prep_naive(const float* __restrict__ z, const float* __restrict__ qgain, const float* __restrict__ kgain, float* __restrict__ qr, float* __restrict__ kr) {
    const int gid = blockIdx.x * 64 + threadIdx.x;
    const int tok = gid % T, hh = gid / T;
    const int t = tok % S, row = t / GW, col = t % GW;
    const float* src = z + (size_t)tok * ZA + (hh < 8 ? OFF_QG + hh * 64 : OFF_KG + (hh - 8) * 64);
    const float* gain = hh < 8 ? qgain : kgain;
    float v[64]; float ss = 0.f;
#pragma unroll
    for (int d = 0; d < 64; ++d) { v[d] = src[d]; ss = fmaf(v[d], v[d], ss); }
    const float rs = 1.0f / sqrtf(ss * (1.f / 64.f) + RMS_EPS);
    float* dst = hh < 8 ? (qr + (size_t)tok * 512 + hh * 64) : (kr + (size_t)tok * 128 + (hh - 8) * 64);
#pragma unroll
    for (int i = 0; i < 32; ++i) {
        const float inv = rope_inv(i & 15);
        const float ang = (i < 16 ? (float)row : (float)col) * inv;
        float cs, sn; sincos_acc(ang, sn, cs);
        const float x1 = v[2 * i] * rs * gain[2 * i], x2 = v[2 * i + 1] * rs * gain[2 * i + 1];
        dst[2 * i] = x1 * cs - x2 * sn; dst[2 * i + 1] = x1 * sn + x2 * cs;
    }
}

__global__ void __launch_bounds__(64) gqa_attn_naive(const float* __restrict__ qr, const float* __restrict__ kr, const float* __restrict__ z, float* __restrict__ y) {
    const int gid = blockIdx.x * 64 + threadIdx.x;
    const int t = gid % S, h = (gid / S) % 8, b = gid / (S * 8), kvh = h / 4;
    float q[64], o[64];
    const float* qp = qr + (size_t)(b * S + t) * 512 + h * 64;
#pragma unroll
    for (int d = 0; d < 64; ++d) { q[d] = qp[d]; o[d] = 0.f; }
    float m = -1e30f, l = 0.f;
    const float* kb = kr + (size_t)b * S * 128 + kvh * 64;
    const float* vb = z + (size_t)b * S * ZA + OFF_VG + kvh * 64;
    for (int j = 0; j < S; ++j) {
        const float* kp = kb + (size_t)j * 128;
        float s = 0.f;
#pragma unroll
        for (int d = 0; d < 64; ++d) s = fmaf(q[d], kp[d], s);
        s *= 0.125f;
        const float* vp = vb + (size_t)j * ZA;
        if (s > m) { const float f = expf(m - s); l = l * f + 1.f; m = s;
#pragma unroll
            for (int d = 0; d < 64; ++d) o[d] = fmaf(o[d], f, vp[d]);
        } else { const float p = expf(s - m); l += p;
#pragma unroll
            for (int d = 0; d < 64; ++d) o[d] = fmaf(p, vp[d], o[d]);
        }
    }
    const float il = 1.f / l;
    float* yp = y + (size_t)(b * S + t) * 512 + h * 64;
#pragma unroll
    for (int d = 0; d < 64; ++d) yp[d] = o[d] * il;
}

__global__ void __launch_bounds__(256) mem_attn_naive(const float* __restrict__ z, const float* __restrict__ mkv, float* __restrict__ y) {
    __shared__ float qs[128]; __shared__ float ps[256]; __shared__ float red[8];
    const int bid = blockIdx.x, h = bid % 4, tok = bid / 4, b = tok / S, tid = threadIdx.x;
    if (tid < 128) qs[tid] = z[(size_t)tok * ZA + OFF_QM + h * 128 + tid];
    __syncthreads();
    const float* kp = mkv + (size_t)(b * 256 + tid) * 1024 + h * 128;
    float s = 0.f;
    for (int d = 0; d < 128; ++d) s = fmaf(qs[d], kp[d], s);
    s *= 0.08838834764831845f;
    float mx = s;
    for (int o = 32; o > 0; o >>= 1) mx = fmaxf(mx, __shfl_xor(mx, o));
    if ((tid & 63) == 0) red[tid >> 6] = mx;
    __syncthreads();
    mx = fmaxf(fmaxf(red[0], red[1]), fmaxf(red[2], red[3]));
    const float p = expf(s - mx);
    float sm = p;
    for (int o = 32; o > 0; o >>= 1) sm += __shfl_xor(sm, o);
    if ((tid & 63) == 0) red[4 + (tid >> 6)] = sm;
    ps[tid] = p;
    __syncthreads();
    const float tot = (red[4] + red[5]) + (red[6] + red[7]);
    if (tid < 128) {
        const float* vp = mkv + (size_t)(b * 256) * 1024 + 512 + h * 128 + tid;
        float o = 0.f;
        for (int mm = 0; mm < 256; ++mm) o = fmaf(ps[mm], vp[(size_t)mm * 1024], o);
        y[(size_t)tok * 512 + h * 128 + tid] = o / tot;
    }
}

__global__ void __launch_bounds__(256) ln_naive(const float* __restrict__ in, const float* __restrict__ g, const float* __restrict__ bta, float* __restrict__ out) {
    const int row = blockIdx.x * 4 + (threadIdx.x >> 6), lane = threadIdx.x & 63;
    const float* p = in + (size_t)row * D;
    float v[16]; float s = 0.f;
#pragma unroll
    for (int i = 0; i < 16; ++i) { v[i] = p[lane + 64 * i]; s += v[i]; }
    for (int o = 32; o > 0; o >>= 1) s += __shfl_xor(s, o);
    const float mu = s * (1.f / D); float q = 0.f;
#pragma unroll
    for (int i = 0; i < 16; ++i) { v[i] -= mu; q = fmaf(v[i], v[i], q); }
    for (int o = 32; o > 0; o >>= 1) q += __shfl_xor(q, o);
    const float rstd = 1.0f / sqrtf(q * (1.f / D) + LN_EPS);
#pragma unroll
    for (int i = 0; i < 16; ++i) out[(size_t)row * D + lane + 64 * i] = v[i] * rstd * g[lane + 64 * i] + bta[lane + 64 * i];
}

__global__ void __launch_bounds__(256) router_naive(const float* __restrict__ x1, const float* __restrict__ wr, float* __restrict__ aff) {
    const int tok = blockIdx.x * 4 + (threadIdx.x >> 6), lane = threadIdx.x & 63;
    float acc[16];
#pragma unroll
    for (int e = 0; e < 16; ++e) acc[e] = 0.f;
    for (int i = 0; i < 16; ++i) {
        const int d = lane + 64 * i; const float xv = x1[(size_t)tok * D + d];
#pragma unroll
        for (int e = 0; e < 16; ++e) acc[e] = fmaf(xv, wr[d * 16 + e], acc[e]);
    }
#pragma unroll
    for (int e = 0; e < 16; ++e) for (int o = 32; o > 0; o >>= 1) acc[e] += __shfl_xor(acc[e], o);
    float mx = acc[0];
#pragma unroll
    for (int e = 1; e < 16; ++e) mx = fmaxf(mx, acc[e]);
    float sm = 0.f;
#pragma unroll
    for (int e = 0; e < 16; ++e) { acc[e] = expf(acc[e] - mx); sm += acc[e]; }
    float mine = 0.f;
#pragma unroll
    for (int e = 0; e < 16; ++e) if (lane == e) mine = acc[e] / sm;
    if (lane < 16) aff[(size_t)tok * 16 + lane] = mine;
}

__global__ void __launch_bounds__(1024) topk_naive(const float* __restrict__ aff, int* __restrict__ idx, float* __restrict__ gatev, int* __restrict__ inv) {
    __shared__ float a[S];
    const int b = blockIdx.x / NE, e = blockIdx.x % NE, tid = threadIdx.x;
    for (int i = tid; i < S; i += 1024) a[i] = aff[(size_t)(b * S + i) * 16 + e];
    __syncthreads();
    for (int i = tid; i < S; i += 1024) {
        const float mv = a[i]; int rank = 0;
        for (int j = 0; j < S; ++j) { const float o = a[j]; rank += (o > mv || (o == mv && j < i)) ? 1 : 0; }
        int slot = -1;
        if (rank < CAP) { slot = rank; idx[(b * NE + e) * CAP + rank] = b * S + i; gatev[(b * NE + e) * CAP + rank] = mv; }
        inv[(size_t)(b * S + i) * 16 + e] = slot;
    }
}

__global__ void __launch_bounds__(256) final_naive(const float* __restrict__ x1, const float* __restrict__ ye, const int* __restrict__ inv, const float* __restrict__ g, const float* __restrict__ bta, float* __restrict__ out) {
    const int tok = blockIdx.x * 4 + (threadIdx.x >> 6), lane = threadIdx.x & 63, b = tok / S;
    float v[16]; float ff[16];
#pragma unroll
    for (int i = 0; i < 16; ++i) { v[i] = x1[(size_t)tok * D + lane + 64 * i]; ff[i] = 0.f; }
    for (int e = 0; e < 16; ++e) {
        const int slot = inv[(size_t)tok * 16 + e];
        if (slot >= 0) { const float* yp = ye + (size_t)((b * NE + e) * CAP + slot) * D;
#pragma unroll
            for (int i = 0; i < 16; ++i) ff[i] += yp[lane + 64 * i]; }
    }
    float s = 0.f;
#pragma unroll
    for (int i = 0; i < 16; ++i) { v[i] = ALPHA * v[i] + ff[i]; s += v[i]; }
    for (int o = 32; o > 0; o >>= 1) s += __shfl_xor(s, o);
    const float mu = s * (1.f / D); float q = 0.f;
#pragma unroll
    for (int i = 0; i < 16; ++i) { v[i] -= mu; q = fmaf(v[i], v[i], q); }
    for (int o = 32; o > 0; o >>= 1) q += __shfl_xor(q, o);
    const float rstd = 1.0f / sqrtf(q * (1.f / D) + LN_EPS);
#pragma unroll
    for (int i = 0; i < 16; ++i) out[(size_t)tok * D + lane + 64 * i] = v[i] * rstd * g[lane + 64 * i] + bta[lane + 64 * i];
}
}

namespace nvws {
constexpr size_t ZATT = 0;
constexpr size_t GATES = ZATT + (size_t)16384 * 2816 * 4;
constexpr size_t BR = GATES + (size_t)16384 * 3072 * 4;
constexpr size_t MKV = BR + (size_t)3 * 16384 * 512 * 4;
constexpr size_t QR = MKV + (size_t)1024 * 1024 * 4;
constexpr size_t KR = QR + (size_t)16384 * 512 * 4;
constexpr size_t END1 = KR + (size_t)16384 * 128 * 4;
static_assert(END1 <= (size_t)536870912, "ws");
constexpr size_t MERGED = 0, Y1 = (size_t)16384 * 1024 * 4, X1 = 2 * Y1;
constexpr size_t ACT = 3 * Y1;
constexpr size_t YE = ACT + (size_t)32768 * 1024 * 4;
constexpr size_t AFF = YE + (size_t)32768 * 1024 * 4;
constexpr size_t IDX = AFF + (size_t)16384 * 16 * 4;
constexpr size_t GATEV = IDX + (size_t)32768 * 4;
constexpr size_t INV = GATEV + (size_t)32768 * 4;
constexpr size_t END2 = INV + (size_t)16384 * 16 * 4;
static_assert(END2 <= (size_t)536870912, "ws2");
}

static void naive_forward(void* const* d_in, float* out, char* ws, hipStream_t st) {
    using namespace nv; using namespace nvws;
    const float* x = (const float*)d_in[0]; const float* mem = (const float*)d_in[1]; const float* w_in = (const float*)d_in[2];
    const float* b_gate = (const float*)d_in[3]; const float* rpb = (const float*)d_in[4]; const float* qgain = (const float*)d_in[5];
    const float* kgain = (const float*)d_in[6]; const float* w_mem_kv = (const float*)d_in[7]; const float* w_branch = (const float*)d_in[8];
    const float* w_out = (const float*)d_in[9]; const float* ln1_g = (const float*)d_in[10]; const float* ln1_b = (const float*)d_in[11];
    const float* w_router = (const float*)d_in[12]; const float* w_gate_up = (const float*)d_in[13]; const float* w_down = (const float*)d_in[14];
    const float* ln2_g = (const float*)d_in[15]; const float* ln2_b = (const float*)d_in[16];
    float* zatt = (float*)(ws + ZATT); float* gates = (float*)(ws + GATES); float* br = (float*)(ws + BR); float* mkv = (float*)(ws + MKV);
    float* qr = (float*)(ws + QR); float* kr = (float*)(ws + KR); float* merged = (float*)(ws + MERGED); float* y1 = (float*)(ws + Y1); float* x1 = (float*)(ws + X1);
    float* act = (float*)(ws + ACT); float* ye = (float*)(ws + YE); float* aff = (float*)(ws + AFF); int* idx = (int*)(ws + IDX); float* gatev = (float*)(ws + GATEV); int* inv = (int*)(ws + INV);
    gemm_naive<EpiStore, false, false><<<dim3(ZA / 64, T / 64, 1), 256, 0, st>>>(x, D, nullptr, T, w_in, INW, 0, 1, D, 0, EpiStore{zatt, ZA, 0});
    gemm_naive<EpiGate, false, false><<<dim3(GATEW / 64, T / 64, 1), 256, 0, st>>>(x, D, nullptr, T, w_in + ZA, INW, 0, 1, D, 0, EpiGate{gates, b_gate});
    gemm_naive<EpiStore, false, false><<<dim3(1024 / 64, 1024 / 64, 1), 256, 0, st>>>(mem, D, nullptr, 1024, w_mem_kv, 1024, 0, 1, D, 0, EpiStore{mkv, 1024, 0});
    na_attn_naive<<<NB * 8 * S / 64, 64, 0, st>>>(zatt, rpb, br);
    gqa_prep_naive<<<T * 10 / 64, 64, 0, st>>>(zatt, qgain, kgain, qr, kr);
    gqa_attn_naive<<<NB * 8 * S / 64, 64, 0, st>>>(qr, kr, zatt, br + (size_t)T * 512);
    mem_attn_naive<<<T * 4, 256, 0, st>>>(zatt, mkv, br + (size_t)2 * T * 512);
    for (int g = 0; g < 3; ++g)
        gemm_naive<EpiMerge, false, false><<<dim3(D / 64, T / 64, 1), 256, 0, st>>>(br + (size_t)g * T * 512, 512, nullptr, T, w_branch + (size_t)g * 512 * D, D, 0, 1, 512, 0, EpiMerge{merged, gates, g, 0});
    gemm_naive<EpiResid, false, false><<<dim3(D / 64, T / 64, 1), 256, 0, st>>>(merged, D, nullptr, T, w_out, D, 0, 1, D, 0, EpiResid{y1, x});
    ln_naive<<<T / 4, 256, 0, st>>>(y1, ln1_g, ln1_b, x1);
    router_naive<<<T / 4, 256, 0, st>>>(x1, w_router, aff);
    topk_naive<<<NB * NE, 1024, 0, st>>>(aff, idx, gatev, inv);
    gemm_naive<EpiSwiglu, true, true><<<dim3(DFF / 64, CAP / 64, NB * NE), 256, 0, st>>>(x1, D, idx, CAP, w_gate_up, 2 * DFF, (long)D * 2 * DFF, NE, D, DFF, EpiSwiglu{act});
    gemm_naive<EpiDown, false, false><<<dim3(D / 64, CAP / 64, NB * NE), 256, 0, st>>>(act, DFF, nullptr, CAP, w_down, D, (long)DFF * D, NE, DFF, 0, EpiDown{ye, gatev});
    final_naive<<<T / 4, 256, 0, st>>>(x1, ye, inv, ln2_g, ln2_b, out);
}

extern "C" void kernel_launch(void* const* d_in, const int* in_sizes, int n_in, void* d_out, int out_size, void* d_ws, size_t ws_size, hipStream_t stream) {
    naive_forward(d_in, (float*)d_out, (char*)d_ws, stream);
}
```
